# Optimizing an MI355X kernel written in HIP

```python
import jax, jax.numpy as jnp
from jax import lax
import numpy as np

D_MODEL = 2048
BATCH = 8
SEQ = 2048
DEPTH = 1

GRID_W = 64
MEM_LEN = 256
Q_BLOCK = 128
ROPE_THETA = 10000.0

A_HEADS = 8
A_KV_HEADS = 2
A_GROUP = A_HEADS // A_KV_HEADS
A_HEAD_DIM = 128
A_WIDTH = A_HEADS * A_HEAD_DIM

B_HEADS = 8
B_Q_RANK = 512
B_KV_RANK = 512
B_NOPE = 128
B_ROPE = 64
B_V = 128
B_WIDTH = B_HEADS * B_V

MIX_WIDTH = A_WIDTH + B_WIDTH

COLS_QA = A_HEADS * A_HEAD_DIM
COLS_KA = A_KV_HEADS * A_HEAD_DIM
COLS_VA = A_KV_HEADS * A_HEAD_DIM
COLS_CQ = B_Q_RANK
COLS_CKV = B_KV_RANK
COLS_KR = B_ROPE
IN_COLS = COLS_QA + COLS_KA + COLS_VA + COLS_CQ + COLS_CKV + COLS_KR
SPLITS = (COLS_QA,
          COLS_QA + COLS_KA,
          COLS_QA + COLS_KA + COLS_VA,
          COLS_QA + COLS_KA + COLS_VA + COLS_CQ,
          COLS_QA + COLS_KA + COLS_VA + COLS_CQ + COLS_CKV)

MEM_HEADS = 4
MEM_HEAD_DIM = 128
MEM_WIDTH = MEM_HEADS * MEM_HEAD_DIM

D_FF = 4 * D_MODEL

ALPHA = (2.0 * DEPTH) ** 0.25
BETA = (8.0 * DEPTH) ** -0.25

LN_EPS = 1e-5
RMS_EPS = 1e-6

kernel_name = "hybrid_gqa_mla_deepnorm_encoder"


def layer_norm(x, g, b):
    xf = x.astype(jnp.float32)
    mu = jnp.mean(xf, axis=-1, keepdims=True)
    var = jnp.mean(jnp.square(xf - mu), axis=-1, keepdims=True)
    y = (xf - mu) * lax.rsqrt(var + LN_EPS) * g.astype(jnp.float32) + b.astype(jnp.float32)
    return y.astype(x.dtype)


def rms_norm(x, g):
    xf = x.astype(jnp.float32)
    y = xf * lax.rsqrt(jnp.mean(jnp.square(xf), axis=-1, keepdims=True) + RMS_EPS) * g.astype(jnp.float32)
    return y.astype(x.dtype)


def axial_rope_angles(seq_len, rot_dim):
    rows = seq_len // GRID_W
    row = jnp.repeat(jnp.arange(rows, dtype=jnp.float32), GRID_W)
    col = jnp.tile(jnp.arange(GRID_W, dtype=jnp.float32), rows)
    quarter = rot_dim // 4
    inv_freq = ROPE_THETA ** (-jnp.arange(quarter, dtype=jnp.float32) / quarter)
    return jnp.concatenate([row[:, None] * inv_freq, col[:, None] * inv_freq], axis=-1)


def apply_rope(x, ang):
    xf = x.astype(jnp.float32).reshape(*x.shape[:-1], x.shape[-1] // 2, 2)
    cos = jnp.cos(ang)[None, :, None, :]
    sin = jnp.sin(ang)[None, :, None, :]
    x1, x2 = xf[..., 0], xf[..., 1]
    out = jnp.stack([x1 * cos - x2 * sin, x1 * sin + x2 * cos], axis=-1).reshape(x.shape)
    return out.astype(x.dtype)


def block_attention(q, k, v):
    b, s, kvh, g, dk = q.shape
    dv = v.shape[-1]
    nb = s // Q_BLOCK
    scale = dk ** -0.5
    qb = q.reshape(b, nb, Q_BLOCK, kvh, g, dk).transpose(1, 0, 2, 3, 4, 5)

    def one_block(q_blk):
        scores = jnp.einsum('bqkgd,bskd->bkgqs', q_blk, k,
                            preferred_element_type=jnp.float32) * scale
        probs = jax.nn.softmax(scores, axis=-1).astype(v.dtype)
        return jnp.einsum('bkgqs,bskd->bqkgd', probs, v)

    out = lax.map(one_block, qb)
    return out.transpose(1, 0, 2, 3, 4, 5).reshape(b, s, kvh * g * dv)


def hybrid_mixer(h, ang_a, ang_b, w_in, g_qa, g_ka, g_cq, w_uq, g_ckv, w_ukv, w_out):
    b, s, _ = h.shape
    proj = h @ w_in
    q_a, k_a, v_a, c_q, c_kv, k_r = jnp.split(proj, SPLITS, axis=-1)

    q_a = apply_rope(rms_norm(q_a.reshape(b, s, A_HEADS, A_HEAD_DIM), g_qa), ang_a)
    k_a = apply_rope(rms_norm(k_a.reshape(b, s, A_KV_HEADS, A_HEAD_DIM), g_ka), ang_a)
    v_a = v_a.reshape(b, s, A_KV_HEADS, A_HEAD_DIM)
    o_a = block_attention(q_a.reshape(b, s, A_KV_HEADS, A_GROUP, A_HEAD_DIM), k_a, v_a)

    q_b = (rms_norm(c_q, g_cq) @ w_uq).reshape(b, s, B_HEADS, B_NOPE + B_ROPE)
    q_b = jnp.concatenate([q_b[..., :B_NOPE], apply_rope(q_b[..., B_NOPE:], ang_b)], axis=-1)
    kv_b = (rms_norm(c_kv, g_ckv) @ w_ukv).reshape(b, s, B_HEADS, B_NOPE + B_V)
    k_nope, v_b = kv_b[..., :B_NOPE], kv_b[..., B_NOPE:]
    k_rope = apply_rope(k_r.reshape(b, s, 1, B_ROPE), ang_b)
    k_b = jnp.concatenate([k_nope, jnp.broadcast_to(k_rope, (b, s, B_HEADS, B_ROPE))], axis=-1)
    o_b = block_attention(q_b[:, :, :, None, :], k_b, v_b)

    return jnp.concatenate([o_a, o_b], axis=-1) @ w_out


def memory_cross_attention(h, mem_n, w_q_mem, w_kv_mem, w_o_mem):
    b, s, _ = h.shape
    m = mem_n.shape[1]
    q = (h @ w_q_mem).reshape(b, s, MEM_HEADS, MEM_HEAD_DIM)
    kv = (mem_n @ w_kv_mem).reshape(b, m, 2, MEM_HEADS, MEM_HEAD_DIM)
    k, v = kv[:, :, 0], kv[:, :, 1]
    scores = jnp.einsum('bqhd,bmhd->bhqm', q, k,
                        preferred_element_type=jnp.float32) * (MEM_HEAD_DIM ** -0.5)
    probs = jax.nn.softmax(scores, axis=-1).astype(v.dtype)
    o = jnp.einsum('bhqm,bmhd->bqhd', probs, v).reshape(b, s, MEM_WIDTH)
    return o @ w_o_mem


def squared_relu_mlp(h, w_mlp_in, w_mlp_out):
    return jnp.square(jax.nn.relu(h @ w_mlp_in)) @ w_mlp_out


def setup_inputs(seed: int = 0) -> dict:
    key = jax.random.key(seed)
    ks = jax.random.split(key, 24)
    f32 = jnp.float32

    def w(k, fan_in, fan_out, scale=1.0):
        return jax.random.normal(k, (DEPTH, fan_in, fan_out), f32) * (fan_in ** -0.5) * scale

    def gain(k, n):
        return 1.0 + 0.02 * jax.random.normal(k, (DEPTH, n), f32)

    def bias(k, n):
        return 0.02 * jax.random.normal(k, (DEPTH, n), f32)

    return {
        "x": jax.random.normal(ks[0], (BATCH, SEQ, D_MODEL), f32),
        "mem": jax.random.normal(ks[1], (BATCH, MEM_LEN, D_MODEL), f32),
        "w_in": w(ks[2], D_MODEL, IN_COLS),
        "g_qa": gain(ks[3], A_HEAD_DIM),
        "g_ka": gain(ks[4], A_HEAD_DIM),
        "g_cq": gain(ks[5], B_Q_RANK),
        "w_uq": w(ks[6], B_Q_RANK, B_HEADS * (B_NOPE + B_ROPE)),
        "g_ckv": gain(ks[7], B_KV_RANK),
        "w_ukv": w(ks[8], B_KV_RANK, B_HEADS * (B_NOPE + B_V)),
        "w_out": w(ks[9], MIX_WIDTH, D_MODEL, BETA),
        "ln1_g": gain(ks[10], D_MODEL),
        "ln1_b": bias(ks[11], D_MODEL),
        "mem_ln_g": gain(ks[12], D_MODEL),
        "mem_ln_b": bias(ks[13], D_MODEL),
        "w_q_mem": w(ks[14], D_MODEL, MEM_WIDTH),
        "w_kv_mem": w(ks[15], D_MODEL, 2 * MEM_WIDTH),
        "w_o_mem": w(ks[16], MEM_WIDTH, D_MODEL, BETA),
        "ln2_g": gain(ks[17], D_MODEL),
        "ln2_b": bias(ks[18], D_MODEL),
        "w_mlp_in": w(ks[19], D_MODEL, D_FF, BETA),
        "w_mlp_out": w(ks[20], D_FF, D_MODEL, BETA),
        "ln3_g": gain(ks[21], D_MODEL),
        "ln3_b": bias(ks[22], D_MODEL),
    }


def reference(x, mem, w_in, g_qa, g_ka, g_cq, w_uq, g_ckv, w_ukv, w_out,
              ln1_g, ln1_b, mem_ln_g, mem_ln_b, w_q_mem, w_kv_mem, w_o_mem,
              ln2_g, ln2_b, w_mlp_in, w_mlp_out, ln3_g, ln3_b):
    seq_len = x.shape[1]
    ang_a = axial_rope_angles(seq_len, A_HEAD_DIM)
    ang_b = axial_rope_angles(seq_len, B_ROPE)

    for l in range(DEPTH):
        mix = hybrid_mixer(x, ang_a, ang_b, w_in[l], g_qa[l], g_ka[l], g_cq[l], w_uq[l],
                           g_ckv[l], w_ukv[l], w_out[l])
        x = layer_norm(ALPHA * x + mix, ln1_g[l], ln1_b[l])

        mem_n = layer_norm(mem, mem_ln_g[l], mem_ln_b[l])
        xa = memory_cross_attention(x, mem_n, w_q_mem[l], w_kv_mem[l], w_o_mem[l])
        x = layer_norm(ALPHA * x + xa, ln2_g[l], ln2_b[l])

        ff = squared_relu_mlp(x, w_mlp_in[l], w_mlp_out[l])
        x = layer_norm(ALPHA * x + ff, ln3_g[l], ln3_b[l])
    return x
```

```cpp
#include <hip/hip_runtime.h>
#include <cstdio>
#include <cstdint>

namespace pg8 {
#define PG8_LAS __attribute__((address_space(3)))
typedef unsigned short bf16_t;
typedef short bf16x8 __attribute__((ext_vector_type(8)));
typedef float f32x4 __attribute__((ext_vector_type(4)));
typedef unsigned u32x4 __attribute__((ext_vector_type(4)));
constexpr int BM = 256, BK = 64, HALF = 128, HTB = HALF * BK * 2, STAGE_BYTES = 8 * HTB, NXCD = 8, WGM = 8;

__host__ __device__ __forceinline__ int lds_byte(int r, int c) { const int st = (r >> 4) * 2 + (c >> 5), rr = r & 15, cc = c & 31, ob = rr * 64 + cc * 2; return st * 1024 + (ob ^ (((ob >> 9) & 1) << 5)); }
__host__ __device__ __forceinline__ void stage_rc(int b, int& R, int& C) { const int st = b / 1024, sb = b % 1024, swz = sb ^ (((sb >> 9) & 1) << 5); R = (st >> 1) * 16 + swz / 64; C = (st & 1) * 32 + (swz % 64) / 2; }
__host__ __device__ __forceinline__ int perm32(int rho) { const int n = rho >> 4, i = rho & 15; return 8 * (i >> 2) + 4 * n + (i & 3); }

struct Unit { int pm, pn; };
struct Gemm { const bf16_t* A; const bf16_t* Bt; int M, N, K, lda, ldb; };

struct StaticOrder {
    int nM, nN, nwg, G, c;
    __host__ __device__ void init(int M, int N, int G_, int c_) { nM = M / BM; nN = N / BM; nwg = nM * nN; G = G_; c = c_; }
    __host__ __device__ bool next(int i, Unit& u) const {
        const long L = (long)i * G + c; if (L >= nwg) return false;
        int wgid = (int)L; { const int q = nwg / NXCD, r = nwg % NXCD, xcd = wgid % NXCD, off = wgid / NXCD; wgid = (xcd < r ? xcd * (q + 1) : r * (q + 1) + (xcd - r) * q) + off; }
        const int nig = WGM * nN, gid = wgid / nig, fm = gid * WGM, gsz = (nM - fm) < WGM ? (nM - fm) : WGM;
        u.pm = fm + ((wgid % nig) % gsz); u.pn = (wgid % nig) / gsz; return true;
    }
    __device__ __forceinline__ void a_ready(const Unit&) const {}
    __device__ __forceinline__ void done(const Unit&) const {}
};

__device__ __forceinline__ unsigned cvt_pk_bf16(float lo, float hi) { unsigned r; asm volatile("v_cvt_pk_bf16_f32 %0, %1, %2" : "=v"(r) : "v"(lo), "v"(hi)); return r; }

struct EpiF32 {
    static constexpr bool PERM = false, AFTER_DRAIN = false;
    float* C; int ldc;
    __device__ __forceinline__ void operator()(const f32x4 (&acc)[2][2][4][2], const Unit& u, int wr, int wc, int fr, int fq) const {
        const int row0 = u.pm * BM + wr * 64 + fr, col0 = u.pn * BM + wc * 32 + 4 * fq;
#pragma unroll
        for (int ai = 0; ai < 2; ++ai)
#pragma unroll
            for (int m = 0; m < 4; ++m) { float* rowp = C + (size_t)(row0 + ai * HALF + m * 16) * ldc + col0;
#pragma unroll
                for (int bj = 0; bj < 2; ++bj)
#pragma unroll
                    for (int n = 0; n < 2; ++n) *(f32x4*)(rowp + bj * HALF + n * 16) = acc[ai][bj][m][n]; }
    }
};
template <int ACT  > struct EpiBf16 {
    static constexpr bool PERM = true, AFTER_DRAIN = false;
    bf16_t* O; int ldc;
    __device__ __forceinline__ void operator()(const f32x4 (&acc)[2][2][4][2], const Unit& u, int wr, int wc, int fr, int fq) const {
        const int row0 = u.pm * BM + wr * 64 + fr, col0 = u.pn * BM + wc * 32 + 8 * fq;
#pragma unroll
        for (int ai = 0; ai < 2; ++ai)
#pragma unroll
            for (int m = 0; m < 4; ++m) { bf16_t* rowp = O + (size_t)(row0 + ai * HALF + m * 16) * ldc + col0;
#pragma unroll
                for (int bj = 0; bj < 2; ++bj) { f32x4 v0 = acc[ai][bj][m][0], v1 = acc[ai][bj][m][1];
                    if (ACT == 2) {
#pragma unroll
                        for (int e = 0; e < 4; ++e) { const float a = fmaxf(v0[e], 0.f), b = fmaxf(v1[e], 0.f); v0[e] = a * a; v1[e] = b * b; } }
                    u32x4 w; w.x = cvt_pk_bf16(v0[0], v0[1]); w.y = cvt_pk_bf16(v0[2], v0[3]); w.z = cvt_pk_bf16(v1[0], v1[1]); w.w = cvt_pk_bf16(v1[2], v1[3]);
                    *(u32x4*)(rowp + bj * HALF) = w; } }
    }
};

template <class Epi, class Sched, bool ALIGN_EPI = false, bool SP2 = false>
__device__ __forceinline__ void gemm_phase(PG8_LAS unsigned char* lds, const Gemm g, const Sched& S, const Epi& E) {
    const int tid = threadIdx.x, wid = __builtin_amdgcn_readfirstlane(tid >> 6), lane = tid & 63, wr = wid >> 2, wc = wid & 3, fr = lane & 15, fq = lane >> 4;
    const int K = g.K, nt = K / BK;
    unsigned voffA[2], voffB[2];
#pragma unroll
    for (int i = 0; i < 2; ++i) { int R, C; stage_rc(tid * 16 + i * 8192, R, C); const int Rb = Epi::PERM ? ((R & ~31) + perm32(R & 31)) : R;
        voffA[i] = (unsigned)(R * g.lda + C) * 2u; voffB[i] = (unsigned)(Rb * g.ldb + C) * 2u; }
    const size_t kstep = (size_t)(BK * 2);
    const size_t hstepA = (size_t)HALF * g.lda * 2, hstepB = (size_t)HALF * g.ldb * 2;
    const size_t tstepA = 2 * hstepA, tstepB = 2 * hstepB;
    const unsigned ldsw = (unsigned)wid * 1024u;
    const int aoff = lds_byte(wr * 64 + fr, fq * 8), boff = lds_byte(wc * 32 + fr, fq * 8);
#define PG8_SA(b, h) (((b) * 2 + (h)) * HTB)
#define PG8_SB(b, h) ((4 + (b) * 2 + (h)) * HTB)
#define PG8_STAGE(bufoff, gbase, voff) do { _Pragma("unroll") for (int _i = 0; _i < 2; ++_i) \
        __builtin_amdgcn_global_load_lds((const unsigned*)((const char*)(gbase) + (voff)[_i]), (PG8_LAS unsigned*)(lds + (bufoff) + ldsw + _i * 8192), 16, 0, 0); } while (0)
#define PG8_LDA(dst, b, h) do { _Pragma("unroll") for (int m = 0; m < 4; ++m) _Pragma("unroll") for (int k = 0; k < 2; ++k) dst[m][k] = *(const PG8_LAS bf16x8*)(lds + PG8_SA(b, h) + aoff + m * 2048 + k * 1024); } while (0)
#define PG8_LDB(dst, b, h) do { _Pragma("unroll") for (int n = 0; n < 2; ++n) _Pragma("unroll") for (int k = 0; k < 2; ++k) dst[n][k] = *(const PG8_LAS bf16x8*)(lds + PG8_SB(b, h) + boff + n * 2048 + k * 1024); } while (0)
#define PG8_MMA(ai, bj, At, Bt) do { __builtin_amdgcn_s_setprio(1); _Pragma("unroll") for (int m = 0; m < 4; ++m) _Pragma("unroll") for (int n = 0; n < 2; ++n) _Pragma("unroll") for (int k = 0; k < 2; ++k) \
        acc[ai][bj][m][n] = __builtin_amdgcn_mfma_f32_16x16x32_bf16(Bt[n][k], At[m][k], acc[ai][bj][m][n], 0, 0, 0); __builtin_amdgcn_s_setprio(0); } while (0)
#define PG8_WAIT_V(n) asm volatile("s_waitcnt vmcnt(" #n ")" ::: "memory")
#define PG8_WAIT_L(n) asm volatile("s_waitcnt lgkmcnt(" #n ")" ::: "memory")
#define PG8_BAR __builtin_amdgcn_s_barrier()
#define PG8_SCHED __builtin_amdgcn_sched_barrier(0)
    Unit cur, nxt; int ui = 0;
    if (!S.next(0, cur)) return;
    f32x4 acc[2][2][4][2];
#pragma unroll
    for (int a = 0; a < 2; ++a)
#pragma unroll
        for (int b = 0; b < 2; ++b)
#pragma unroll
            for (int m = 0; m < 4; ++m)
#pragma unroll
                for (int n = 0; n < 2; ++n) acc[a][b][m][n] = (f32x4){0.f, 0.f, 0.f, 0.f};
    bf16x8 At[4][2], B0[2][2], B1[2][2];
    const char* cA = (const char*)g.A + (size_t)cur.pm * tstepA; const char* cB = (const char*)g.Bt + (size_t)cur.pn * tstepB;
    S.a_ready(cur);
    if constexpr (SP2) {
        PG8_STAGE(PG8_SB(0, 0), cB, voffB); PG8_STAGE(PG8_SB(0, 1), cB + hstepB, voffB); PG8_STAGE(PG8_SA(0, 0), cA, voffA); PG8_STAGE(PG8_SA(0, 1), cA + hstepA, voffA);
        if (wr == 1) PG8_BAR;
        PG8_WAIT_V(2); PG8_BAR;
        PG8_STAGE(PG8_SB(1, 0), cB + kstep, voffB); PG8_STAGE(PG8_SA(1, 0), cA + kstep, voffA); PG8_STAGE(PG8_SB(1, 1), cB + hstepB + kstep, voffB);
        PG8_WAIT_V(6); PG8_BAR;
    } else {
        PG8_STAGE(PG8_SB(0, 0), cB, voffB); PG8_STAGE(PG8_SA(0, 0), cA, voffA); PG8_STAGE(PG8_SB(0, 1), cB + hstepB, voffB); PG8_STAGE(PG8_SA(0, 1), cA + hstepA, voffA);
        if (wr == 1) PG8_BAR;
        PG8_WAIT_V(4); PG8_BAR;
        PG8_STAGE(PG8_SB(1, 0), cB + kstep, voffB); PG8_STAGE(PG8_SA(1, 0), cA + kstep, voffA); PG8_STAGE(PG8_SB(1, 1), cB + hstepB + kstep, voffB);
        PG8_WAIT_V(6); PG8_BAR;
    }
    for (;;) {
        const bool has_next = S.next(ui + 1, nxt);
        const char* nA = has_next ? (const char*)g.A + (size_t)nxt.pm * tstepA : cA; const char* nB = has_next ? (const char*)g.Bt + (size_t)nxt.pn * tstepB : cB;
        for (int t = 0; t < nt; t += 2) {
            const bool last = (t == nt - 2);
            const char* a1 = cA + (size_t)(t + 1) * kstep;
            const char* a2 = last ? nA : cA + (size_t)(t + 2) * kstep; const char* b2 = last ? nB : cB + (size_t)(t + 2) * kstep;
            const char* a3 = a2 + kstep; const char* b3 = b2 + kstep;
            if (last && has_next) S.a_ready(nxt);
            if constexpr (SP2) {
            PG8_LDB(B0, 0, 0); PG8_LDB(B1, 0, 1); PG8_SCHED; PG8_LDA(At, 0, 0); PG8_STAGE(PG8_SA(1, 1), a1 + hstepA, voffA);
            PG8_WAIT_V(8); PG8_WAIT_L(0); PG8_BAR; PG8_MMA(0, 0, At, B0); PG8_MMA(0, 1, At, B1); PG8_BAR; PG8_SCHED;
            PG8_LDA(At, 0, 1); PG8_STAGE(PG8_SB(0, 0), b2, voffB); PG8_STAGE(PG8_SB(0, 1), b2 + hstepB, voffB); PG8_STAGE(PG8_SA(0, 0), a2, voffA);
            PG8_WAIT_V(8); PG8_WAIT_L(0); PG8_BAR; PG8_MMA(1, 0, At, B0); PG8_MMA(1, 1, At, B1); PG8_BAR; PG8_SCHED;
            PG8_LDB(B0, 1, 0); PG8_LDB(B1, 1, 1); PG8_SCHED; PG8_LDA(At, 1, 0); PG8_STAGE(PG8_SA(0, 1), a2 + hstepA, voffA);
            PG8_WAIT_V(8); PG8_WAIT_L(0); PG8_BAR; PG8_MMA(0, 0, At, B0); PG8_MMA(0, 1, At, B1); PG8_BAR; PG8_SCHED;
            PG8_LDA(At, 1, 1); PG8_STAGE(PG8_SB(1, 0), b3, voffB); PG8_STAGE(PG8_SB(1, 1), b3 + hstepB, voffB); PG8_STAGE(PG8_SA(1, 0), a3, voffA);
            PG8_WAIT_V(8); PG8_WAIT_L(0); PG8_BAR; PG8_MMA(1, 0, At, B0); PG8_MMA(1, 1, At, B1); PG8_BAR; PG8_SCHED;
            } else {
            PG8_LDB(B0, 0, 0); PG8_SCHED; PG8_LDA(At, 0, 0); PG8_STAGE(PG8_SA(1, 1), a1 + hstepA, voffA);
            PG8_WAIT_L(8); PG8_BAR; PG8_WAIT_L(0); PG8_MMA(0, 0, At, B0); PG8_BAR; PG8_SCHED;
            PG8_LDB(B1, 0, 1); PG8_STAGE(PG8_SB(0, 0), b2, voffB);
            PG8_BAR; PG8_WAIT_L(0); PG8_MMA(0, 1, At, B1); PG8_BAR;
            PG8_LDA(At, 0, 1); PG8_STAGE(PG8_SA(0, 0), a2, voffA);
            PG8_BAR; PG8_WAIT_L(0); PG8_MMA(1, 0, At, B0); PG8_BAR; PG8_SCHED;
            PG8_STAGE(PG8_SB(0, 1), b2 + hstepB, voffB);
            PG8_WAIT_V(6); PG8_BAR; PG8_MMA(1, 1, At, B1); PG8_BAR;
            PG8_LDB(B0, 1, 0); PG8_SCHED; PG8_LDA(At, 1, 0); PG8_STAGE(PG8_SA(0, 1), a2 + hstepA, voffA);
            PG8_WAIT_L(8); PG8_BAR; PG8_WAIT_L(0); PG8_MMA(0, 0, At, B0); PG8_BAR; PG8_SCHED;
            PG8_LDB(B1, 1, 1); PG8_STAGE(PG8_SB(1, 0), b3, voffB);
            PG8_BAR; PG8_WAIT_L(0); PG8_MMA(0, 1, At, B1); PG8_BAR;
            PG8_LDA(At, 1, 1); PG8_STAGE(PG8_SA(1, 0), a3, voffA);
            PG8_BAR; PG8_WAIT_L(0); PG8_MMA(1, 0, At, B0); PG8_BAR; PG8_SCHED;
            PG8_STAGE(PG8_SB(1, 1), b3 + hstepB, voffB);
            PG8_WAIT_V(6); PG8_BAR; PG8_MMA(1, 1, At, B1); PG8_BAR;
            }
        }
        if constexpr (ALIGN_EPI) { if (wr == 0) PG8_BAR; }
        if constexpr (!Epi::AFTER_DRAIN) { E(acc, cur, wr, wc, fr, fq); S.done(cur); }
        if (!has_next) break;
#pragma unroll
        for (int a = 0; a < 2; ++a)
#pragma unroll
            for (int b = 0; b < 2; ++b)
#pragma unroll
                for (int m = 0; m < 4; ++m)
#pragma unroll
                    for (int n = 0; n < 2; ++n) acc[a][b][m][n] = (f32x4){0.f, 0.f, 0.f, 0.f};
        cur = nxt; cA = nA; cB = nB; ++ui;
        if constexpr (ALIGN_EPI) { if (wr == 1) PG8_BAR; }
    }
    PG8_WAIT_V(0);
    if constexpr (!ALIGN_EPI) { if (wr == 0) PG8_BAR; }
    PG8_BAR;
#undef PG8_SA
#undef PG8_SB
#undef PG8_STAGE
#undef PG8_LDA
#undef PG8_LDB
#undef PG8_MMA
#undef PG8_WAIT_V
#undef PG8_WAIT_L
#undef PG8_BAR
#undef PG8_SCHED
}
}

namespace att {
typedef unsigned short bf16_t;
using bf16x8 = __attribute__((ext_vector_type(8))) short;
using s16x4  = __attribute__((ext_vector_type(4))) short;
using f32x16 = __attribute__((ext_vector_type(16))) float;
using u32x4  = __attribute__((ext_vector_type(4))) unsigned;
constexpr int NW = 8, QBLK = 32, KVBLK = 64;
constexpr int SHM_V = KVBLK * 128 * 2, SHM_K1 = KVBLK * 128 * 2, SHM_K2 = KVBLK * 64 * 2;
constexpr int OFF_V = 0, OFF_K1 = 2 * SHM_V, OFF_K2 = OFF_K1 + 2 * SHM_K1, OFF_WS = OFF_K2 + 2 * SHM_K2, OFF_QR = OFF_WS + NW * 64 * 4, LDS_BYTES = OFF_QR + NW * 4096;
#define KSWZ(row, colB) ((row) * 256 + ((colB) ^ (((row) & 7) << 4)))
#define K2SWZ(row, colB) ((row) * 128 + ((colB) ^ ((((row) >> 1) & 7) << 4)))
#define SBAR() __builtin_amdgcn_sched_barrier(0)
__device__ __forceinline__ int crow(int r, int hi) { return (r & 3) + 8 * (r >> 2) + 4 * hi; }
__device__ __forceinline__ unsigned cvtpk(float lo, float hi) { unsigned r; asm volatile("v_cvt_pk_bf16_f32 %0, %1, %2" : "=v"(r) : "v"(lo), "v"(hi)); return r; }

__device__ __forceinline__ void partialSM(f32x16& p0, f32x16& p1, float& m_reg, float& mn, float& alpha, const float C, const float thr_raw) {
  float pmax = p0[0];
#pragma unroll
  for (int r = 1; r < 16; ++r) pmax = fmaxf(pmax, p0[r]);
#pragma unroll
  for (int r = 0; r < 16; ++r) pmax = fmaxf(pmax, p1[r]);
  { auto rr = __builtin_amdgcn_permlane32_swap(__float_as_uint(pmax), __float_as_uint(pmax), false, false);
    pmax = fmaxf(__uint_as_float(rr[0]), __uint_as_float(rr[1])); }
  if (__builtin_expect(__all(pmax - m_reg <= thr_raw), 1)) { mn = m_reg; alpha = 1.f; }
  else { mn = fmaxf(m_reg, pmax); alpha = __builtin_amdgcn_exp2f((m_reg - mn) * C); m_reg = mn; }
  const float mnC = -mn * C;
#pragma unroll
  for (int r = 0; r < 16; ++r) p0[r] = fmaf(p0[r], C, mnC);
#pragma unroll
  for (int r = 0; r < 16; ++r) p1[r] = fmaf(p1[r], C, mnC);
#pragma unroll
  for (int r = 0; r < 16; ++r) p0[r] = __builtin_amdgcn_exp2f(p0[r]);
}
__device__ __forceinline__ void finishSM(f32x16& p0, f32x16& p1, float alpha, float& l_reg, bf16x8& pa0, bf16x8& pa1, bf16x8& pa2, bf16x8& pa3) {
#pragma unroll
  for (int r = 0; r < 16; ++r) p1[r] = __builtin_amdgcn_exp2f(p1[r]);
  float ps = 0;
#pragma unroll
  for (int r = 0; r < 16; ++r) ps += p0[r];
#pragma unroll
  for (int r = 0; r < 16; ++r) ps += p1[r];
  { auto rr = __builtin_amdgcn_permlane32_swap(__float_as_uint(ps), __float_as_uint(ps), false, false);
    ps = __uint_as_float(rr[0]) + __uint_as_float(rr[1]); }
  l_reg = l_reg * alpha + ps;
#define PK4(P, BASE, OUT) do { unsigned a0 = cvtpk(P[BASE + 0], P[BASE + 1]), a1 = cvtpk(P[BASE + 2], P[BASE + 3]);   \
    unsigned b0 = cvtpk(P[BASE + 4], P[BASE + 5]), b1 = cvtpk(P[BASE + 6], P[BASE + 7]);                              \
    auto r0 = __builtin_amdgcn_permlane32_swap(a0, b0, false, false); auto r1 = __builtin_amdgcn_permlane32_swap(a1, b1, false, false); \
    u32x4 w = {r0[0], r1[0], r0[1], r1[1]}; OUT = *reinterpret_cast<bf16x8*>(&w); } while (0)
  PK4(p0, 0, pa0); PK4(p0, 8, pa1); PK4(p1, 0, pa2); PK4(p1, 8, pa3);
#undef PK4
}
template <int DK>
__device__ __forceinline__ void qkt(f32x16& p0, f32x16& p1, const char* K1s, const char* K2s, const bf16x8* qr, const char* qrl, int r32, int hi) {
  p0 = f32x16{}; p1 = f32x16{};
#pragma unroll
  for (int d0 = 0; d0 < 8; ++d0) { const int cb = (d0 * 16 + hi * 8) * 2;
    bf16x8 b0 = *reinterpret_cast<const bf16x8*>(K1s + KSWZ(r32, cb));
    bf16x8 b1 = *reinterpret_cast<const bf16x8*>(K1s + KSWZ(32 + r32, cb));
    p0 = __builtin_amdgcn_mfma_f32_32x32x16_bf16(b0, qr[d0], p0, 0, 0, 0);
    p1 = __builtin_amdgcn_mfma_f32_32x32x16_bf16(b1, qr[d0], p1, 0, 0, 0); }
  if constexpr (DK == 192) {
#pragma unroll
    for (int d0 = 0; d0 < 4; ++d0) { const int cb = (d0 * 16 + hi * 8) * 2;
      bf16x8 b0 = *reinterpret_cast<const bf16x8*>(K2s + K2SWZ(r32, cb));
      bf16x8 b1 = *reinterpret_cast<const bf16x8*>(K2s + K2SWZ(32 + r32, cb));
      const bf16x8 qx = *reinterpret_cast<const bf16x8*>(qrl + d0 * 1024);
      p0 = __builtin_amdgcn_mfma_f32_32x32x16_bf16(b0, qx, p0, 0, 0, 0);
      p1 = __builtin_amdgcn_mfma_f32_32x32x16_bf16(b1, qx, p1, 0, 0, 0); }
  }
}
__device__ __forceinline__ int v_st(int k, int c) { const int kk = (k & ~0xC) | ((k & 4) << 1) | ((k & 8) >> 1); return ((kk >> 3) * 4 + (c >> 5)) * 512 + ((kk & 7) * 32 + (c & 31)) * 2; }
__device__ __forceinline__ int v_rd_base(int lane) { return ((lane & 3) << 3) | (((lane >> 2) & 3) << 6) | (((lane >> 4) & 1) << 5) | (((lane >> 5) & 1) << 8); }
constexpr int v_rd_off(int d0, int ks, int half) { return d0 * 512 + ks * 4096 + half * 2048; }
template <int OFF> __device__ __forceinline__ s16x4 tr_read(int vb) {
  s16x4 r; asm volatile("ds_read_b64_tr_b16 %0, %1 offset:%2" : "=&v"(r) : "v"(vb), "i"(OFF) : "memory"); return r;
}
template <int D0> __device__ __forceinline__ void pv_one(f32x16& od, int vb, bf16x8 pa0, bf16x8 pa1, bf16x8 pa2, bf16x8 pa3) {
  const s16x4 l0 = tr_read<v_rd_off(D0, 0, 0)>(vb), h0 = tr_read<v_rd_off(D0, 0, 1)>(vb), l1 = tr_read<v_rd_off(D0, 1, 0)>(vb), h1 = tr_read<v_rd_off(D0, 1, 1)>(vb);
  const s16x4 l2 = tr_read<v_rd_off(D0, 2, 0)>(vb), h2 = tr_read<v_rd_off(D0, 2, 1)>(vb), l3 = tr_read<v_rd_off(D0, 3, 0)>(vb), h3 = tr_read<v_rd_off(D0, 3, 1)>(vb);
  asm volatile("s_waitcnt lgkmcnt(0)" ::: "memory"); SBAR();
#define PK(L, H) (bf16x8){L[0], L[1], L[2], L[3], H[0], H[1], H[2], H[3]}
  od = __builtin_amdgcn_mfma_f32_32x32x16_bf16(pa0, PK(l0, h0), od, 0, 0, 0);
  od = __builtin_amdgcn_mfma_f32_32x32x16_bf16(pa1, PK(l1, h1), od, 0, 0, 0);
  od = __builtin_amdgcn_mfma_f32_32x32x16_bf16(pa2, PK(l2, h2), od, 0, 0, 0);
  od = __builtin_amdgcn_mfma_f32_32x32x16_bf16(pa3, PK(l3, h3), od, 0, 0, 0);
#undef PK
}
__device__ __forceinline__ void pv_d0(f32x16* o, int vb, bf16x8 pa0, bf16x8 pa1, bf16x8 pa2, bf16x8 pa3) {
  pv_one<0>(o[0], vb, pa0, pa1, pa2, pa3); pv_one<1>(o[1], vb, pa0, pa1, pa2, pa3); pv_one<2>(o[2], vb, pa0, pa1, pa2, pa3); pv_one<3>(o[3], vb, pa0, pa1, pa2, pa3);
}

template <int DK, int SD, int ldq, int ldk1, int ldk2, int ldv, int ldo, int seq>
__device__ __forceinline__ void attn_unit(const bf16_t* __restrict__ Qb, const bf16_t* __restrict__ K1, const bf16_t* __restrict__ K2,
                                          const bf16_t* __restrict__ Vp, bf16_t* __restrict__ Ob, const float C, const float thr_raw, char* lds) {
  constexpr int NQ = 8;
  int tid_ = threadIdx.x; asm volatile("" : "+v"(tid_));
  const int tid = tid_, wid = tid >> 6, lane = tid & 63, r32 = lane & 31, hi = lane >> 5;
  char* V_lds = lds + OFF_V; char* K1_lds = lds + OFF_K1; char* K2_lds = lds + OFF_K2;
  float* ws = (float*)(lds + OFF_WS) + wid * 64; float* li_l = ws; float* al_l = ws + 32;
  float m_reg = -1e30f, l_reg = 0; f32x16 o[4] = {}; bf16x8 qr[NQ];
  const bf16_t* Qw = Qb + (long)(wid * QBLK + r32) * ldq + hi * 8;
#pragma unroll
  for (int d0 = 0; d0 < NQ; ++d0) qr[d0] = *reinterpret_cast<const bf16x8*>(Qw + d0 * 16);
  char* qrl = lds + OFF_QR + wid * 4096 + lane * 16;
  if constexpr (DK == 192) {
#pragma unroll
    for (int d0 = 0; d0 < 4; ++d0) *reinterpret_cast<bf16x8*>(qrl + d0 * 1024) = *reinterpret_cast<const bf16x8*>(Qw + 128 + d0 * 16);
  }
  const int sr = tid >> 4, sc = (tid & 15) * 8, vst0 = v_st(sr, sc), vst1 = v_st(32 + sr, sc);
  const int sr2 = tid >> 3, sc2 = (tid & 7) * 8;
  const int vb0 = (int)(uintptr_t)V_lds + v_rd_base(lane);
  struct { bf16x8 vs0, vs1, ks0, ks1, k2; } sr_[SD];
#define SLOAD(i, k0) do { sr_[i].vs0 = *reinterpret_cast<const bf16x8*>(&Vp[(long)((k0) + sr) * ldv + sc]); sr_[i].vs1 = *reinterpret_cast<const bf16x8*>(&Vp[(long)((k0) + 32 + sr) * ldv + sc]); \
    sr_[i].ks0 = *reinterpret_cast<const bf16x8*>(&K1[(long)((k0) + sr) * ldk1 + sc]); sr_[i].ks1 = *reinterpret_cast<const bf16x8*>(&K1[(long)((k0) + 32 + sr) * ldk1 + sc]); \
    if constexpr (DK == 192) sr_[i].k2 = *reinterpret_cast<const bf16x8*>(&K2[(long)((k0) + sr2) * ldk2 + sc2]); } while (0)
#define SWRITE(b, i) do { *(bf16x8*)(V_lds + (b) * SHM_V + vst0) = sr_[i].vs0;          \
    *(bf16x8*)(V_lds + (b) * SHM_V + vst1) = sr_[i].vs1; const int kc = sc * 2;               \
    *(bf16x8*)(K1_lds + (b) * SHM_K1 + KSWZ(sr, kc)) = sr_[i].ks0;                       \
    *(bf16x8*)(K1_lds + (b) * SHM_K1 + KSWZ(32 + sr, kc)) = sr_[i].ks1;                  \
    if constexpr (DK == 192) *(bf16x8*)(K2_lds + (b) * SHM_K2 + K2SWZ(sr2, sc2 * 2)) = sr_[i].k2; } while (0)
#define SWAIT() do { if constexpr (SD == 2) { if constexpr (DK == 192) asm volatile("s_waitcnt vmcnt(5)" ::: "memory"); else asm volatile("s_waitcnt vmcnt(4)" ::: "memory"); } \
    else asm volatile("s_waitcnt vmcnt(0)" ::: "memory"); } while (0)
#define RESC(a) do { if (__any((a) < 1.f)) { if (hi == 0) al_l[r32] = (a); asm volatile("s_waitcnt lgkmcnt(0)" ::: "memory"); \
    _Pragma("unroll") for (int d = 0; d < 4; ++d) _Pragma("unroll") for (int r = 0; r < 16; ++r) o[d][r] *= al_l[crow(r, hi)]; } } while (0)
  f32x16 pA0, pA1, pB0, pB1; float mnA, mnB, alA, alB; bf16x8 pa0, pa1, pa2, pa3; const int NT = seq / KVBLK;
  constexpr int SE = 0, SO = SD - 1;
  SLOAD(SE, 0); asm volatile("s_waitcnt vmcnt(0)" ::: "memory"); SWRITE(0, SE); __syncthreads();
  qkt<DK>(pA0, pA1, K1_lds, K2_lds, qr, qrl, r32, hi); partialSM(pA0, pA1, m_reg, mnA, alA, C, thr_raw);
  SLOAD(SO, KVBLK); if constexpr (SD == 2) { if (2 < NT) SLOAD(SE, 2 * KVBLK); }
  SWAIT(); SWRITE(1, SO); __syncthreads();
  for (int j = 1; j + 1 < NT; j += 2) {
    SBAR(); qkt<DK>(pB0, pB1, K1_lds + SHM_K1, K2_lds + SHM_K2, qr, qrl, r32, hi);
    finishSM(pA0, pA1, alA, l_reg, pa0, pa1, pa2, pa3); SBAR();
    SLOAD(SO, (j + SD) * KVBLK); SBAR();
    pv_d0(o, vb0, pa0, pa1, pa2, pa3); partialSM(pB0, pB1, m_reg, mnB, alB, C, thr_raw);
    __syncthreads(); SWAIT(); SWRITE(0, SE);
    RESC(alB); __syncthreads();
    SBAR(); qkt<DK>(pA0, pA1, K1_lds, K2_lds, qr, qrl, r32, hi);
    finishSM(pB0, pB1, alB, l_reg, pa0, pa1, pa2, pa3); SBAR();
    if (SD == 1 || j + 3 < NT) SLOAD(SE, (j + 1 + SD) * KVBLK); SBAR();
    pv_d0(o, vb0 + SHM_V, pa0, pa1, pa2, pa3); partialSM(pA0, pA1, m_reg, mnA, alA, C, thr_raw);
    __syncthreads(); SWAIT(); SWRITE(1, SO);
    RESC(alA); __syncthreads();
  }
  SBAR(); qkt<DK>(pB0, pB1, K1_lds + SHM_K1, K2_lds + SHM_K2, qr, qrl, r32, hi);
  finishSM(pA0, pA1, alA, l_reg, pa0, pa1, pa2, pa3); SBAR();
  pv_d0(o, vb0, pa0, pa1, pa2, pa3); partialSM(pB0, pB1, m_reg, mnB, alB, C, thr_raw);
  __syncthreads(); RESC(alB);
  finishSM(pB0, pB1, alB, l_reg, pa0, pa1, pa2, pa3); SBAR();
  pv_d0(o, vb0 + SHM_V, pa0, pa1, pa2, pa3);
  if (hi == 0) li_l[r32] = l_reg; asm volatile("s_waitcnt lgkmcnt(0)" ::: "memory");
  float rli[16];
#pragma unroll
  for (int r = 0; r < 16; ++r) rli[r] = __builtin_amdgcn_rcpf(li_l[crow(r, hi)]);
  __syncthreads();
  bf16_t* stg = (bf16_t*)(lds + wid * 8192);
#pragma unroll
  for (int r = 0; r < 16; ++r) { const int orow = crow(r, hi);
#pragma unroll
    for (int d0 = 0; d0 < 4; ++d0) { const float v = o[d0][r] * rli[r]; const unsigned u = __builtin_bit_cast(unsigned, v); stg[orow * 128 + d0 * 32 + r32] = (bf16_t)((u + 0x7fffu + ((u >> 16) & 1u)) >> 16); } }
  asm volatile("s_waitcnt lgkmcnt(0)" ::: "memory");
  bf16_t* Ow = Ob + (long)(wid * QBLK) * ldo;
#pragma unroll
  for (int i = 0; i < 8; ++i) { const int idx = i * 64 + lane, row = idx >> 4, ch = idx & 15;
    const u32x4 v = *(const u32x4*)(stg + row * 128 + ch * 8); *(u32x4*)(Ow + (long)row * ldo + ch * 8) = v; }
  __syncthreads();
#undef SLOAD
#undef SWRITE
#undef SWAIT
#undef RESC
}
#undef SBAR
}

typedef unsigned short bf16;
typedef unsigned v4u __attribute__((ext_vector_type(4)));
typedef unsigned v2u __attribute__((ext_vector_type(2)));
typedef float f32x4 __attribute__((ext_vector_type(4)));
typedef float f32x2 __attribute__((ext_vector_type(2)));
#define LAS __attribute__((address_space(3)))
constexpr int NWAVES = 8;
constexpr int BATCH = 8, SEQ = 2048, DM = 2048, MTOK = BATCH * SEQ;
constexpr int MEMLEN = 256, MMEM = BATCH * MEMLEN;
constexpr int IN_COLS = 2624, NPROJ = 2816;
constexpr int C_QA = 0, C_KA = 1024, C_VA = 1280, C_CQ = 1536, C_CKV = 2048, C_KR = 2560;
constexpr int NQB = 1536, NKVB = 2048, DFF = 8192, MEMW = 512;
constexpr float ALPHA = 1.189207115002721f;
constexpr float LN_EPS = 1e-5f, RMS_EPS = 1e-6f;
constexpr float LOG2E = 1.4426950408889634f;
constexpr size_t MiB = 1u << 20;
constexpr size_t WS_CTL = 0, CTL_ZERO_BYTES = 65536;
constexpr size_t WS_TAB = 1 * MiB;
constexpr size_t WS_KVM = 2 * MiB;
constexpr size_t WS_WIN = 8 * MiB, WS_WUQ = 19 * MiB, WS_WUKV = WS_WUQ + 3 * MiB / 2, WS_WOUT = WS_WUKV + 2 * MiB, WS_WQM = WS_WOUT + 8 * MiB,
                 WS_WKVM = WS_WQM + 2 * MiB, WS_WOM = WS_WKVM + 4 * MiB, WS_W1 = WS_WOM + 2 * MiB, WS_W2 = WS_W1 + 32 * MiB, WS_WEND = WS_W2 + 32 * MiB;
static_assert(WS_WEND <= 104 * MiB, "weights region");
constexpr size_t WS_R = 104 * MiB;
constexpr size_t WS_PROJ = WS_R;
constexpr size_t WS_QA = 280 * MiB, WS_KA = 312 * MiB, WS_VA = 320 * MiB, WS_KR = 328 * MiB, WS_CQ = 330 * MiB, WS_CKV = 346 * MiB, WS_MEMN = 364 * MiB;
constexpr size_t WS_QB = 104 * MiB, WS_KVB = 152 * MiB, WS_O = 216 * MiB;
constexpr size_t WS_QM = 104 * MiB, WS_OM = 120 * MiB, WS_XA = 136 * MiB;
constexpr size_t WS_H = 104 * MiB, WS_FF = 360 * MiB, WS_XB = 448 * MiB, WS_END = 512 * MiB;
constexpr int CW_BAR = 1024;
constexpr int RING_BYTES = 131072, MISC_OFF = RING_BYTES + 320, LDS_BYTES = 147456;
static_assert(att::LDS_BYTES <= RING_BYTES, "attention LDS");

__device__ __forceinline__ unsigned f2bf(float f) { unsigned u = __builtin_bit_cast(unsigned, f); return (u + 0x7fffu + ((u >> 16) & 1u)) >> 16; }
__device__ __forceinline__ unsigned pk2(float lo, float hi) { return f2bf(lo) | (f2bf(hi) << 16); }
__device__ __forceinline__ float bflo(unsigned w) { return __builtin_bit_cast(float, w << 16); }
__device__ __forceinline__ float bfhi(unsigned w) { return __builtin_bit_cast(float, w & 0xffff0000u); }
__device__ __forceinline__ float wave_sum(float v) {
#pragma unroll
    for (int o = 1; o < 64; o <<= 1) v += __shfl_xor(v, o);
    return v;
}

#define XB_TMO      128
#define XB_XCNT(j)  (256  + 64 * (j))
#define XB_XSUB(j)  (1280 + 64 * (j))
#define XB_XGEN(j)  (2304 + 64 * (j))
#define XB_TOP      3328
#define XB_TOPGEN   3392
#define XCD_BAR_WORDS 3456
#define XB_SPIN_CAP (1u << 18)
__device__ __forceinline__ unsigned xb_ld(unsigned* p)              { return __hip_atomic_load(p, __ATOMIC_RELAXED, __HIP_MEMORY_SCOPE_AGENT); }
__device__ __forceinline__ unsigned xb_add(unsigned* p, unsigned v) { return __hip_atomic_fetch_add(p, v, __ATOMIC_RELAXED, __HIP_MEMORY_SCOPE_AGENT); }
__device__ __forceinline__ unsigned xb_xcc_id() { return (unsigned)__builtin_amdgcn_s_getreg((3 << 11) | 20) & 0xFu; }
#define XB_SPIN(cond, bar) do { unsigned _sp = 0; while (cond) { __builtin_amdgcn_s_sleep(1); \
    if ((++_sp & 255u) == 0u) { if (xb_ld(&(bar)[XB_TMO])) break; if (_sp > XB_SPIN_CAP) { atomicAdd(&(bar)[XB_TMO], 1u); break; } } } } while (0)
struct XcdBarrier { unsigned* bar; unsigned x; volatile LAS unsigned* st; };
__device__ __forceinline__ XcdBarrier xcd_barrier_post(unsigned* bar, volatile LAS unsigned* st) {
    XcdBarrier b; b.bar = bar; b.x = xb_xcc_id(); b.st = st;
    if (threadIdx.x == 0) (void)xb_add(&bar[XB_XCNT(b.x)], 1u);
    return b;
}
__device__ __forceinline__ void xcd_barrier_complete(unsigned* bar, unsigned x, unsigned& nloc, unsigned& nx) {
    const unsigned G = gridDim.x * gridDim.y * gridDim.z;
    unsigned sum, cnt, mine, sp = 0u;
    for (;;) {
        sum = 0u; cnt = 0u; mine = 0u;
#pragma unroll
        for (unsigned j = 0; j < 16; ++j) { const unsigned c = xb_ld(&bar[XB_XCNT(j)]); sum += c; cnt += (c > 0u) ? 1u : 0u; mine = (j == x) ? c : mine; }
        if (sum == G) break;
        __builtin_amdgcn_s_sleep(1);
        if ((++sp & 255u) == 0u) { if (xb_ld(&bar[XB_TMO])) break; if (sp > XB_SPIN_CAP) { atomicAdd(&bar[XB_TMO], 1u); break; } }
    }
    nloc = mine > 0u ? mine : 1u; nx = cnt > 0u ? cnt : 1u;
}
__device__ __forceinline__ void xcd_barrier(const XcdBarrier& b) {
    asm volatile("s_waitcnt vmcnt(0)" ::: "memory");
    __syncthreads();
    if (threadIdx.x == 0) {
        unsigned* bar = b.bar;
        __builtin_amdgcn_s_waitcnt(0);
        unsigned nloc = b.st[0], nx = b.st[1];
        if (nloc == 0u) { xcd_barrier_complete(bar, b.x, nloc, nx); b.st[0] = nloc; b.st[1] = nx; }
        const unsigned old = xb_add(&bar[XB_XSUB(b.x)], 1u);
        const unsigned gen = old / nloc;
        if (old + 1u == (gen + 1u) * nloc) {
            __builtin_amdgcn_fence(__ATOMIC_RELEASE, "agent");
            asm volatile("s_waitcnt vmcnt(0)" ::: "memory");
            const unsigned og = xb_add(&bar[XB_TOP], 1u);
            const unsigned tg = og / nx;
            if (og + 1u == (tg + 1u) * nx) xb_add(&bar[XB_TOPGEN], 1u);
            else XB_SPIN(xb_ld(&bar[XB_TOPGEN]) == tg, bar);
            __builtin_amdgcn_fence(__ATOMIC_ACQUIRE, "agent");
            xb_add(&bar[XB_XGEN(b.x)], 1u);
            asm volatile("s_waitcnt vmcnt(0)" ::: "memory");
        } else {
            XB_SPIN(xb_ld(&bar[XB_XGEN(b.x)]) == gen, bar);
            __builtin_amdgcn_fence(__ATOMIC_ACQUIRE, "agent");
            asm volatile("s_waitcnt vmcnt(0)" ::: "memory");
        }
    }
    __syncthreads();
}

__device__ __forceinline__ void transpose_item(const float* W, int K, int N, bf16* WT, LAS float* scr, int item, int lane) {
    const int nblk = N / 32, kb = item / nblk, nb = item % nblk, k0 = 64 * kb, n0 = 32 * nb;
#pragma unroll 8
    for (int i = 0; i < 32; ++i) { const int kk = 2 * i + (lane >> 5); scr[kk * 33 + (lane & 31)] = W[(size_t)(k0 + kk) * N + n0 + (lane & 31)]; }
    asm volatile("s_waitcnt lgkmcnt(0)" ::: "memory");
    const int c = lane & 7;
#pragma unroll
    for (int j = 0; j < 4; ++j) { const int n = (lane >> 3) + 8 * j; const LAS float* s = scr + (8 * c) * 33 + n;
        v4u o; o.x = pk2(s[0 * 33], s[1 * 33]); o.y = pk2(s[2 * 33], s[3 * 33]); o.z = pk2(s[4 * 33], s[5 * 33]); o.w = pk2(s[6 * 33], s[7 * 33]);
        *(v4u*)(WT + (size_t)(n0 + n) * K + k0 + 8 * c) = o; }
    asm volatile("s_waitcnt lgkmcnt(0)" ::: "memory");
}
__device__ __forceinline__ void ln_row(const float* r, float ca, const float* add, const float* g, const float* b, float* of, bf16* ob, int lane) {
    f32x4 v[8]; float s = 0.f;
#pragma unroll
    for (int j = 0; j < 8; ++j) { v[j] = ((const f32x4*)r)[64 * j + lane] * ca; if (add) v[j] += ((const f32x4*)add)[64 * j + lane]; s += (v[j].x + v[j].y) + (v[j].z + v[j].w); }
    const float mean = wave_sum(s) * (1.f / DM); float s2 = 0.f;
#pragma unroll
    for (int j = 0; j < 8; ++j) { v[j] = v[j] - mean; s2 += (v[j].x * v[j].x + v[j].y * v[j].y) + (v[j].z * v[j].z + v[j].w * v[j].w); }
    const float rstd = 1.f / sqrtf(wave_sum(s2) * (1.f / DM) + LN_EPS);
#pragma unroll
    for (int j = 0; j < 8; ++j) { const f32x4 gg = ((const f32x4*)g)[64 * j + lane], bb = ((const f32x4*)b)[64 * j + lane]; const f32x4 o = v[j] * rstd * gg + bb;
        if (of) ((f32x4*)of)[64 * j + lane] = o;
        if (ob) { v2u w; w.x = pk2(o.x, o.y); w.y = pk2(o.z, o.w); ((v2u*)ob)[64 * j + lane] = w; } }
}
__device__ __forceinline__ void sincos_d(float af, float& c, float& s) {
    const double a = (double)af; const double kq = __builtin_rint(a * 0.63661977236758134308); const int q = (int)kq;
    const double r = (a - kq * 1.57079632679489655800) - kq * 6.12323399573676603587e-17; const double r2 = r * r;
    double sp = -7.6471637318198164759e-13; sp = sp * r2 + 1.6059043836821614599e-10; sp = sp * r2 - 2.5052108385441718775e-08; sp = sp * r2 + 2.7557319223985890653e-06;
    sp = sp * r2 - 1.9841269841269841270e-04; sp = sp * r2 + 8.3333333333333333333e-03; sp = sp * r2 - 1.6666666666666666667e-01; sp = r + r * r2 * sp;
    double cp = 4.7794773323873852974e-14; cp = cp * r2 - 1.1470745597729724714e-11; cp = cp * r2 + 2.0876756987868098979e-09; cp = cp * r2 - 2.7557319223985890653e-07;
    cp = cp * r2 + 2.4801587301587301587e-05; cp = cp * r2 - 1.3888888888888888889e-03; cp = cp * r2 + 4.1666666666666666667e-02; cp = cp * r2 - 0.5; cp = 1.0 + r2 * cp;
    double ss, cc; switch (q & 3) { case 0: ss = sp; cc = cp; break; case 1: ss = cp; cc = -sp; break; case 2: ss = -sp; cc = -cp; break; default: ss = -cp; cc = sp; break; }
    c = (float)cc; s = (float)ss;
}

struct Args { const float* in[23]; float* out; unsigned char* ws; int ph_lo, ph_hi; };
enum { I_X = 0, I_MEM, I_WIN, I_GQA, I_GKA, I_GCQ, I_WUQ, I_GCKV, I_WUKV, I_WOUT, I_LN1G, I_LN1B, I_MLNG, I_MLNB, I_WQM, I_WKVM, I_WOM, I_LN2G, I_LN2B, I_W1, I_W2, I_LN3G, I_LN3B };
constexpr int N_PHASES = 15;

__global__ void __launch_bounds__(NWAVES * 64, 2) fwd_kernel(Args args) {
    extern __shared__ __attribute__((aligned(16))) unsigned char lds[];
    LAS unsigned char* ldsl = (LAS unsigned char*)lds;
    volatile LAS unsigned* MISC = (volatile LAS unsigned*)(ldsl + MISC_OFF);
    const int tid = threadIdx.x, lane = tid & 63, wave = __builtin_amdgcn_readfirstlane(tid >> 6);
    const int G = gridDim.x, bx = blockIdx.x;
    const int vcu = (G % 8 == 0) ? (bx % 8) * (G / 8) + bx / 8 : bx;
    unsigned char* ws = args.ws;
    unsigned* ctl = (unsigned*)(ws + WS_CTL);
    for (int u = tid; u < (LDS_BYTES - RING_BYTES) / 4; u += NWAVES * 64) ((LAS unsigned*)(ldsl + RING_BYTES))[u] = 0u;
    __syncthreads();
    XcdBarrier bar = xcd_barrier_post(ctl + CW_BAR, MISC + 8);
    const int lo = args.ph_lo, hi = args.ph_hi;
#define IN(k) (lo <= (k) && (k) < hi)
#define SEAM(k) do { if (IN(k) && IN((k) + 1)) xcd_barrier(bar); } while (0)
    const int gw = vcu * NWAVES + wave, NGW = G * NWAVES;
    const int gt = bx * (NWAVES * 64) + tid, NGT = G * NWAVES * 64;

    const float* x = args.in[I_X]; float* out = args.out;
    bf16* WinT = (bf16*)(ws + WS_WIN); bf16* WuqT = (bf16*)(ws + WS_WUQ); bf16* WukvT = (bf16*)(ws + WS_WUKV); bf16* WoutT = (bf16*)(ws + WS_WOUT);
    bf16* WqmT = (bf16*)(ws + WS_WQM); bf16* WkvmT = (bf16*)(ws + WS_WKVM); bf16* WomT = (bf16*)(ws + WS_WOM); bf16* W1T = (bf16*)(ws + WS_W1); bf16* W2T = (bf16*)(ws + WS_W2);
    bf16* XB = (bf16*)(ws + WS_XB); bf16* MEMN = (bf16*)(ws + WS_MEMN); bf16* KVM = (bf16*)(ws + WS_KVM);
    float* PROJ = (float*)(ws + WS_PROJ);
    bf16* QA = (bf16*)(ws + WS_QA); bf16* KA = (bf16*)(ws + WS_KA); bf16* VA = (bf16*)(ws + WS_VA); bf16* KR = (bf16*)(ws + WS_KR); bf16* CQ = (bf16*)(ws + WS_CQ); bf16* CKV = (bf16*)(ws + WS_CKV);
    bf16* QB = (bf16*)(ws + WS_QB); bf16* KVB = (bf16*)(ws + WS_KVB); bf16* OB = (bf16*)(ws + WS_O);
    bf16* QM = (bf16*)(ws + WS_QM); bf16* OM = (bf16*)(ws + WS_OM); float* XA = (float*)(ws + WS_XA);
    bf16* HB = (bf16*)(ws + WS_H); float* FF = (float*)(ws + WS_FF);
    const f32x2* TAB = (const f32x2*)(ws + WS_TAB);

    if (IN(0)) {
        LAS float* scr = (LAS float*)(ldsl + wave * 16384);
        constexpr int I0 = (2048 / 64) * (IN_COLS / 32), I1 = (512 / 64) * (NQB / 32), I2 = (512 / 64) * (NKVB / 32), I3 = (2048 / 64) * (2048 / 32), I4 = (2048 / 64) * (512 / 32),
                      I5 = (2048 / 64) * (1024 / 32), I6 = (512 / 64) * (2048 / 32), I7 = (2048 / 64) * (DFF / 32), I8 = (DFF / 64) * (2048 / 32);
        constexpr int NITEMS = I0 + I1 + I2 + I3 + I4 + I5 + I6 + I7 + I8;
        for (int it = gw; it < NITEMS; it += NGW) {
            int r = it;
            if (r < I0) { transpose_item(args.in[I_WIN], 2048, IN_COLS, WinT, scr, r, lane); continue; } r -= I0;
            if (r < I1) { transpose_item(args.in[I_WUQ], 512, NQB, WuqT, scr, r, lane); continue; } r -= I1;
            if (r < I2) { transpose_item(args.in[I_WUKV], 512, NKVB, WukvT, scr, r, lane); continue; } r -= I2;
            if (r < I3) { transpose_item(args.in[I_WOUT], 2048, 2048, WoutT, scr, r, lane); continue; } r -= I3;
            if (r < I4) { transpose_item(args.in[I_WQM], 2048, 512, WqmT, scr, r, lane); continue; } r -= I4;
            if (r < I5) { transpose_item(args.in[I_WKVM], 2048, 1024, WkvmT, scr, r, lane); continue; } r -= I5;
            if (r < I6) { transpose_item(args.in[I_WOM], 512, 2048, WomT, scr, r, lane); continue; } r -= I6;
            if (r < I7) { transpose_item(args.in[I_W1], 2048, DFF, W1T, scr, r, lane); continue; } r -= I7;
            transpose_item(args.in[I_W2], DFF, 2048, W2T, scr, r, lane);
        }
        for (int i = gt; i < (NPROJ - IN_COLS) * 2048 / 8; i += NGT) ((v4u*)(WinT + (size_t)IN_COLS * 2048))[i] = (v4u){0u, 0u, 0u, 0u};
        for (int i = gt; i < MTOK * DM / 8; i += NGT) { const f32x4 a = ((const f32x4*)x)[2 * i], b = ((const f32x4*)x)[2 * i + 1];
            v4u o; o.x = pk2(a.x, a.y); o.y = pk2(a.z, a.w); o.z = pk2(b.x, b.y); o.w = pk2(b.z, b.w); ((v4u*)XB)[i] = o; }
        for (int m = gw; m < MMEM; m += NGW) ln_row(args.in[I_MEM] + (size_t)m * DM, 1.f, nullptr, args.in[I_MLNG], args.in[I_MLNB], nullptr, MEMN + (size_t)m * DM, lane);
        if (gt < 64 * 32) { const int pos = gt >> 5, j = gt & 31; const float inv = exp2f(-(float)j * (13.287712379549449f / 32.f)); const float ang = (float)pos * inv;
            float c, s; sincos_d(ang, c, s); ((f32x2*)(ws + WS_TAB))[gt] = (f32x2){c, s}; }
    }
    SEAM(0);
    if (IN(1)) {
        { pg8::Gemm g{XB, WinT, MTOK, NPROJ, 2048, 2048, 2048}; pg8::StaticOrder S; S.init(MTOK, NPROJ, G, bx); pg8::EpiF32 E{PROJ, NPROJ};
          pg8::gemm_phase<pg8::EpiF32, pg8::StaticOrder, true, true>(ldsl, g, S, E); }
        { pg8::Gemm g{MEMN, WkvmT, MMEM, 1024, 2048, 2048, 2048}; pg8::StaticOrder S; S.init(MMEM, 1024, G, bx); pg8::EpiBf16<0> E{KVM, 1024};
          pg8::gemm_phase<pg8::EpiBf16<0>, pg8::StaticOrder, true, true>(ldsl, g, S, E); }
    }
    SEAM(1);
    if (IN(2)) {
        const float* gqa = args.in[I_GQA]; const float* gka = args.in[I_GKA]; const float* gcq = args.in[I_GCQ]; const float* gckv = args.in[I_GCKV];
        for (int m = gw; m < MTOK; m += NGW) {
            const float* p = PROJ + (size_t)m * NPROJ; const int s = m & (SEQ - 1), prow = s >> 6, pcol = s & 63;
            const f32x2 csA = (lane < 32) ? TAB[prow * 32 + lane] : TAB[pcol * 32 + lane - 32];
#pragma unroll
            for (int hd = 0; hd < 10; ++hd) {
                const f32x2 v = *(const f32x2*)(p + hd * 128 + 2 * lane);
                const float ss = wave_sum(v.x * v.x + v.y * v.y); const float rinv = 1.f / sqrtf(ss * (1.f / 128.f) + RMS_EPS);
                const f32x2 gg = *(const f32x2*)((hd < 8 ? gqa : gka) + 2 * lane);
                const float a = v.x * rinv * gg.x, b = v.y * rinv * gg.y;
                const unsigned w = pk2(a * csA.x - b * csA.y, a * csA.y + b * csA.x);
                bf16* dst = (hd < 8) ? QA + (size_t)m * 1024 + hd * 128 : KA + (size_t)m * 256 + (hd - 8) * 128;
                ((unsigned*)dst)[lane] = w;
            }
            { const f32x4 v = *(const f32x4*)(p + C_VA + 4 * lane); v2u w; w.x = pk2(v.x, v.y); w.y = pk2(v.z, v.w); ((v2u*)(VA + (size_t)m * 256))[lane] = w; }
#pragma unroll
            for (int t = 0; t < 2; ++t) {
                const float* pc = p + (t == 0 ? C_CQ : C_CKV) + 8 * lane; const float* gp = (t == 0 ? gcq : gckv) + 8 * lane;
                const f32x4 a = *(const f32x4*)pc, b = *(const f32x4*)(pc + 4);
                const float ss = wave_sum((a.x * a.x + a.y * a.y) + (a.z * a.z + a.w * a.w) + (b.x * b.x + b.y * b.y) + (b.z * b.z + b.w * b.w));
                const float rinv = 1.f / sqrtf(ss * (1.f / 512.f) + RMS_EPS);
                const f32x4 ga = *(const f32x4*)gp, gb = *(const f32x4*)(gp + 4);
                v4u w; w.x = pk2(a.x * rinv * ga.x, a.y * rinv * ga.y); w.y = pk2(a.z * rinv * ga.z, a.w * rinv * ga.w);
                w.z = pk2(b.x * rinv * gb.x, b.y * rinv * gb.y); w.w = pk2(b.z * rinv * gb.z, b.w * rinv * gb.w);
                ((v4u*)((t == 0 ? CQ : CKV) + (size_t)m * 512))[lane] = w;
            }
            if (lane < 32) { const f32x2 v = *(const f32x2*)(p + C_KR + 2 * lane);
                const f32x2 cs = (lane < 16) ? TAB[prow * 32 + 2 * lane] : TAB[pcol * 32 + 2 * (lane - 16)];
                ((unsigned*)(KR + (size_t)m * 64))[lane] = pk2(v.x * cs.x - v.y * cs.y, v.x * cs.y + v.y * cs.x); }
        }
    }
    SEAM(2);
    if (IN(3)) {
        { pg8::Gemm g{CQ, WuqT, MTOK, NQB, 512, 512, 512}; pg8::StaticOrder S; S.init(MTOK, NQB, G, bx); pg8::EpiBf16<0> E{QB, NQB};
          pg8::gemm_phase<pg8::EpiBf16<0>, pg8::StaticOrder, true, true>(ldsl, g, S, E); }
        { pg8::Gemm g{CKV, WukvT, MTOK, NKVB, 512, 512, 512}; pg8::StaticOrder S; S.init(MTOK, NKVB, G, bx); pg8::EpiBf16<0> E{KVB, NKVB};
          pg8::gemm_phase<pg8::EpiBf16<0>, pg8::StaticOrder, true, true>(ldsl, g, S, E); }
    }
    SEAM(3);
    if (IN(4)) {
        for (int m = gw; m < MTOK; m += NGW) {
            const int s = m & (SEQ - 1), prow = s >> 6, pcol = s & 63; const int i = lane & 31;
            const f32x2 cs = (i < 16) ? TAB[prow * 32 + 2 * i] : TAB[pcol * 32 + 2 * (i - 16)];
#pragma unroll
            for (int k = 0; k < 4; ++k) { const int h = (lane >> 5) + 2 * k; unsigned* pw = (unsigned*)(QB + (size_t)m * NQB + h * 192 + 128) + i;
                const unsigned w = *pw; const float a = bflo(w), b = bfhi(w); *pw = pk2(a * cs.x - b * cs.y, a * cs.y + b * cs.x); }
        }
    }
    SEAM(4);
    if (IN(5)) {
        const float CA = 0.08838834764831845f * LOG2E, TA = 8.f / 0.08838834764831845f;
        const float CB = 0.07216878364870323f * LOG2E, TB = 8.f / 0.07216878364870323f;
        for (int L = vcu; L < 512; L += G) {
            const int kvh = L >> 8, v = L & 255, b = v >> 5, c = v & 31, h = kvh * 4 + (c >> 3), qb = c & 7; const size_t row0 = (size_t)b * SEQ + qb * 256, kr0 = (size_t)b * SEQ;
            att::attn_unit<128, 2, 1024, 256, 64, 256, 2048, SEQ>(QA + row0 * 1024 + h * 128, KA + kr0 * 256 + kvh * 128, nullptr, VA + kr0 * 256 + kvh * 128,
                                   OB + row0 * 2048 + h * 128, CA, TA, (char*)lds);
        }
        for (int L = vcu; L < 512; L += G) {
            const int rd = L >> 8, v = L & 255, b = v >> 5, c = v & 31, h = rd * 4 + (c >> 3), qb = c & 7; const size_t row0 = (size_t)b * SEQ + qb * 256, kr0 = (size_t)b * SEQ;
            att::attn_unit<192, 1, NQB, NKVB, 64, NKVB, 2048, SEQ>(QB + row0 * NQB + h * 192, KVB + kr0 * NKVB + h * 256, KR + kr0 * 64, KVB + kr0 * NKVB + h * 256 + 128,
                                   OB + row0 * 2048 + 1024 + h * 128, CB, TB, (char*)lds);
        }
    }
    SEAM(5);
    if (IN(6)) {
        pg8::Gemm g{OB, WoutT, MTOK, DM, 2048, 2048, 2048}; pg8::StaticOrder S; S.init(MTOK, DM, G, bx); pg8::EpiF32 E{out, DM};
        pg8::gemm_phase<pg8::EpiF32, pg8::StaticOrder, true, true>(ldsl, g, S, E);
    }
    SEAM(6);
    if (IN(7)) {
        for (int m = gw; m < MTOK; m += NGW) ln_row(x + (size_t)m * DM, ALPHA, out + (size_t)m * DM, args.in[I_LN1G], args.in[I_LN1B], out + (size_t)m * DM, XB + (size_t)m * DM, lane);
    }
    SEAM(7);
    if (IN(8)) {
        pg8::Gemm g{XB, WqmT, MTOK, MEMW, 2048, 2048, 2048}; pg8::StaticOrder S; S.init(MTOK, MEMW, G, bx); pg8::EpiBf16<0> E{QM, MEMW};
        pg8::gemm_phase<pg8::EpiBf16<0>, pg8::StaticOrder, true, true>(ldsl, g, S, E);
    }
    SEAM(8);
    if (IN(9)) {
        const float CA = 0.08838834764831845f * LOG2E, TA = 8.f / 0.08838834764831845f;
        for (int L = vcu; L < 256; L += G) {
            const int b = L >> 5, h = (L >> 3) & 3, qb = L & 7; const size_t row0 = (size_t)b * SEQ + qb * 256, kr0 = (size_t)b * MEMLEN;
            att::attn_unit<128, 2, MEMW, 1024, 64, 1024, MEMW, MEMLEN>(QM + row0 * MEMW + h * 128, KVM + kr0 * 1024 + h * 128, nullptr, KVM + kr0 * 1024 + 512 + h * 128,
                                   OM + row0 * MEMW + h * 128, CA, TA, (char*)lds);
        }
    }
    SEAM(9);
    if (IN(10)) {
        pg8::Gemm g{OM, WomT, MTOK, DM, 512, 512, 512}; pg8::StaticOrder S; S.init(MTOK, DM, G, bx); pg8::EpiF32 E{XA, DM};
        pg8::gemm_phase<pg8::EpiF32, pg8::StaticOrder, true, true>(ldsl, g, S, E);
    }
    SEAM(10);
    if (IN(11)) {
        for (int m = gw; m < MTOK; m += NGW) ln_row(out + (size_t)m * DM, ALPHA, XA + (size_t)m * DM, args.in[I_LN2G], args.in[I_LN2B], out + (size_t)m * DM, XB + (size_t)m * DM, lane);
    }
    SEAM(11);
    if (IN(12)) {
        pg8::Gemm g{XB, W1T, MTOK, DFF, 2048, 2048, 2048}; pg8::StaticOrder S; S.init(MTOK, DFF, G, bx); pg8::EpiBf16<2> E{HB, DFF};
        pg8::gemm_phase<pg8::EpiBf16<2>, pg8::StaticOrder, true, true>(ldsl, g, S, E);
    }
    SEAM(12);
    if (IN(13)) {
        pg8::Gemm g{HB, W2T, MTOK, DM, DFF, DFF, DFF}; pg8::StaticOrder S; S.init(MTOK, DM, G, bx); pg8::EpiF32 E{FF, DM};
        pg8::gemm_phase<pg8::EpiF32, pg8::StaticOrder, true, true>(ldsl, g, S, E);
    }
    SEAM(13);
    if (IN(14)) {
        for (int m = gw; m < MTOK; m += NGW) ln_row(out + (size_t)m * DM, ALPHA, FF + (size_t)m * DM, args.in[I_LN3G], args.in[I_LN3B], out + (size_t)m * DM, nullptr, lane);
    }
#undef IN
#undef SEAM
}

extern "C" void kernel_launch(void* const* d_in, const int* in_sizes, int n_in, void* d_out, int out_size, void* d_ws, size_t ws_size, hipStream_t stream) {
    static int grid = 0;
    if (grid == 0) {
        if (n_in != 23 || in_sizes[0] != MTOK * DM || out_size != MTOK * DM || ws_size < WS_END) {
            fprintf(stderr, "kernel_launch: shape mismatch: n_in %d in0 %d out %d ws %zu (need >= %zu)\n", n_in, n_in > 0 ? in_sizes[0] : -1, out_size, ws_size, (size_t)WS_END); grid = -1; return; }
        int dev = 0, cus = 0, per_cu = 0;
        if (hipGetDevice(&dev) != hipSuccess || hipDeviceGetAttribute(&cus, hipDeviceAttributeMultiprocessorCount, dev) != hipSuccess) { grid = -1; return; }
        if (hipFuncSetAttribute((const void*)fwd_kernel, hipFuncAttributeMaxDynamicSharedMemorySize, LDS_BYTES) != hipSuccess) { fprintf(stderr, "kernel_launch: hipFuncSetAttribute failed\n"); grid = -1; return; }
        if (hipOccupancyMaxActiveBlocksPerMultiprocessor(&per_cu, (const void*)fwd_kernel, NWAVES * 64, LDS_BYTES) != hipSuccess || per_cu < 1) {
            fprintf(stderr, "kernel_launch: occupancy query reports %d workgroups per CU\n", per_cu); (void)hipGetLastError(); grid = -1; return; }
        grid = cus;
    }
    if (grid < 0) return;
    (void)hipMemsetAsync((char*)d_ws + WS_CTL, 0, CTL_ZERO_BYTES, stream);
    Args a{};
    for (int i = 0; i < 23; ++i) a.in[i] = (const float*)d_in[i];
    a.out = (float*)d_out; a.ws = (unsigned char*)d_ws; a.ph_lo = 0; a.ph_hi = N_PHASES;
    hipLaunchKernelGGL(fwd_kernel, dim3(grid), dim3(NWAVES * 64), LDS_BYTES, stream, a);
    const hipError_t le = hipPeekAtLastError();
    if (le != hipSuccess) fprintf(stderr, "kernel_launch: launch failed: %s\n", hipGetErrorName(le));
}
```
